# Optimizing an MI355X kernel written in HIP

```python
import jax, jax.numpy as jnp
from jax import lax
import numpy as np

D_MODEL = 1024
BATCH = 8
SEQ = 2048
DEPTH = 1

GRID_W = 64
CTX_LEN = 256
Q_BLOCK = 128
ROPE_THETA = 10000.0
EPS = 1e-6

A_HEADS = 8
A_KV_HEADS = 2
A_HEAD_DIM = 64
B_HEADS = 8
B_Q_RANK = 384
B_KV_RANK = 256
B_NOPE_DIM = 64
B_ROPE_DIM = 32
B_V_DIM = 64
FFN_HIDDEN = ((8 * D_MODEL // 3 + 255) // 256) * 256

A_SCALE = A_HEAD_DIM ** -0.5
B_SCALE = (B_NOPE_DIM + B_ROPE_DIM) ** -0.5
DEEPNORM_ALPHA = (2.0 * DEPTH) ** 0.25
DEEPNORM_BETA = (8.0 * DEPTH) ** -0.25

IN_SPLIT_SIZES = (
    A_HEADS * A_HEAD_DIM,
    A_KV_HEADS * A_HEAD_DIM,
    A_KV_HEADS * A_HEAD_DIM,
    B_Q_RANK,
    B_KV_RANK,
    B_ROPE_DIM,
    D_MODEL,
    D_MODEL,
)
W_IN_COLS = sum(IN_SPLIT_SIZES)
IN_SPLIT_IDX = tuple(sum(IN_SPLIT_SIZES[:i + 1]) for i in range(len(IN_SPLIT_SIZES) - 1))

kernel_name = "hybrid_gqa_mla_deepnorm_dit_layer"


def layer_norm(x):
    xf = x.astype(jnp.float32)
    mu = jnp.mean(xf, axis=-1, keepdims=True)
    var = jnp.mean(jnp.square(xf - mu), axis=-1, keepdims=True)
    return ((xf - mu) * lax.rsqrt(var + EPS)).astype(x.dtype)


def rms_norm(x, g):
    xf = x.astype(jnp.float32)
    y = xf * lax.rsqrt(jnp.mean(jnp.square(xf), axis=-1, keepdims=True) + EPS)
    return y.astype(x.dtype) * g


def modulate(x, shift, scale):
    return x * (1 + scale) + shift


def post_norm(x, y, g, b):
    return layer_norm(DEEPNORM_ALPHA * x + y) * g + b


def rope_1d(x, pos):
    half = x.shape[-1] // 2
    freqs = ROPE_THETA ** (-jnp.arange(half, dtype=jnp.float32) / half)
    ang = pos.astype(jnp.float32)[:, None] * freqs[None, :]
    cos = jnp.cos(ang)[None, :, None, :].astype(x.dtype)
    sin = jnp.sin(ang)[None, :, None, :].astype(x.dtype)
    x1, x2 = x[..., :half], x[..., half:]
    return jnp.concatenate([x1 * cos - x2 * sin, x1 * sin + x2 * cos], axis=-1)


def axial_rope(x, rows, cols):
    d = x.shape[-1] // 2
    return jnp.concatenate([rope_1d(x[..., :d], rows), rope_1d(x[..., d:], cols)], axis=-1)


def project_streams(h, w_in, q_norm_a, k_norm_a, cq_norm, ckv_norm, w_uq, w_ukv, rows, cols):
    b, t, _ = h.shape
    p = h @ w_in
    q_a, k_a, v_a, c_q, c_kv, k_r, g_a, g_b = jnp.split(p, IN_SPLIT_IDX, axis=-1)
    q_a = rms_norm(q_a.reshape(b, t, A_HEADS, A_HEAD_DIM), q_norm_a)
    k_a = rms_norm(k_a.reshape(b, t, A_KV_HEADS, A_HEAD_DIM), k_norm_a)
    v_a = v_a.reshape(b, t, A_KV_HEADS, A_HEAD_DIM)
    q_b = (rms_norm(c_q, cq_norm) @ w_uq).reshape(b, t, B_HEADS, B_NOPE_DIM + B_ROPE_DIM)
    q_nope, q_rope = q_b[..., :B_NOPE_DIM], q_b[..., B_NOPE_DIM:]
    kv = (rms_norm(c_kv, ckv_norm) @ w_ukv).reshape(b, t, B_HEADS, B_NOPE_DIM + B_V_DIM)
    k_nope, v_b = kv[..., :B_NOPE_DIM], kv[..., B_NOPE_DIM:]
    k_r = k_r[:, :, None, :]
    if rows is not None:
        q_a = axial_rope(q_a, rows, cols)
        k_a = axial_rope(k_a, rows, cols)
        q_rope = axial_rope(q_rope, rows, cols)
        k_r = axial_rope(k_r, rows, cols)
    q_b = jnp.concatenate([q_nope, q_rope], axis=-1)
    k_b = jnp.concatenate([k_nope, jnp.broadcast_to(k_r, (b, t, B_HEADS, B_ROPE_DIM))], axis=-1)
    return q_a, k_a, v_a, q_b, k_b, v_b, g_a, g_b


def block_attention(q, k, v, scale):
    b, s, h, dq = q.shape
    hkv, dv = k.shape[2], v.shape[-1]
    g = h // hkv
    nblk = s // Q_BLOCK
    qb = q.reshape(b, nblk, Q_BLOCK, hkv, g, dq).transpose(1, 0, 2, 3, 4, 5)

    def one_block(q_blk):
        sc = jnp.einsum('bqkgd,btkd->bkgqt', q_blk, k).astype(jnp.float32) * scale
        p = jax.nn.softmax(sc, axis=-1).astype(v.dtype)
        return jnp.einsum('bkgqt,btkd->bqkgd', p, v)

    out = lax.map(one_block, qb)
    return out.transpose(1, 0, 2, 3, 4, 5).reshape(b, s, h * dv)


def merge_branches(o_a, o_b, g_a, g_b, w_proj_a, w_proj_b, w_out):
    y = jax.nn.sigmoid(g_a) * (o_a @ w_proj_a) + jax.nn.sigmoid(g_b) * (o_b @ w_proj_b)
    return y @ w_out


def swiglu(h, w_up, w_down):
    a, u = jnp.split(h @ w_up, 2, axis=-1)
    return (jax.nn.silu(a) * u) @ w_down


def setup_inputs(seed: int = 0) -> dict:
    key = jax.random.key(seed)
    ks = jax.random.split(key, 24)
    L, D, F = DEPTH, D_MODEL, FFN_HIDDEN
    nrm = lambda k, shape, s: jax.random.normal(k, shape, jnp.float32) * s
    return {
        "x": nrm(ks[0], (BATCH, SEQ, D), 1.0),
        "c": nrm(ks[1], (BATCH, D), 1.0),
        "ctx": nrm(ks[2], (BATCH, CTX_LEN, D), 1.0),
        "c_ctx": nrm(ks[3], (D,), 1.0),
        "w_mod": nrm(ks[4], (L, D, 6 * D), D ** -0.5),
        "b_mod": nrm(ks[5], (L, 6 * D), 0.02),
        "w_in": nrm(ks[6], (L, D, W_IN_COLS), D ** -0.5),
        "q_norm_a": 1.0 + nrm(ks[7], (L, A_HEAD_DIM), 0.02),
        "k_norm_a": 1.0 + nrm(ks[8], (L, A_HEAD_DIM), 0.02),
        "cq_norm": 1.0 + nrm(ks[9], (L, B_Q_RANK), 0.02),
        "ckv_norm": 1.0 + nrm(ks[10], (L, B_KV_RANK), 0.02),
        "w_uq": nrm(ks[11], (L, B_Q_RANK, B_HEADS * (B_NOPE_DIM + B_ROPE_DIM)), B_Q_RANK ** -0.5),
        "w_ukv": nrm(ks[12], (L, B_KV_RANK, B_HEADS * (B_NOPE_DIM + B_V_DIM)), B_KV_RANK ** -0.5),
        "w_proj_a": nrm(ks[13], (L, A_HEADS * A_HEAD_DIM, D), (A_HEADS * A_HEAD_DIM) ** -0.5),
        "w_proj_b": nrm(ks[14], (L, B_HEADS * B_V_DIM, D), (B_HEADS * B_V_DIM) ** -0.5),
        "w_out": nrm(ks[15], (L, D, D), DEEPNORM_BETA * D ** -0.5),
        "ln1_g": 1.0 + nrm(ks[16], (L, D), 0.02),
        "ln1_b": nrm(ks[17], (L, D), 0.02),
        "w_up": nrm(ks[18], (L, D, 2 * F), D ** -0.5),
        "w_down": nrm(ks[19], (L, F, D), DEEPNORM_BETA * F ** -0.5),
        "ln2_g": 1.0 + nrm(ks[20], (L, D), 0.02),
        "ln2_b": nrm(ks[21], (L, D), 0.02),
    }


def reference(x, c, ctx, c_ctx, w_mod, b_mod, w_in, q_norm_a, k_norm_a, cq_norm, ckv_norm,
              w_uq, w_ukv, w_proj_a, w_proj_b, w_out, ln1_g, ln1_b, w_up, w_down, ln2_g, ln2_b):
    s = x.shape[1]
    n_rows = s // GRID_W
    rows = jnp.repeat(jnp.arange(n_rows, dtype=jnp.int32), GRID_W)
    cols = jnp.tile(jnp.arange(GRID_W, dtype=jnp.int32), n_rows)

    for l in range(DEPTH):
        mod = jax.nn.silu(c) @ w_mod[l] + b_mod[l]
        sh1, sc1, gt1, sh2, sc2, gt2 = [m[:, None, :] for m in jnp.split(mod, 6, axis=-1)]
        mod_c = jax.nn.silu(c_ctx) @ w_mod[l] + b_mod[l]
        csh1, csc1, cgt1, csh2, csc2, cgt2 = jnp.split(mod_c, 6, axis=-1)

        h = modulate(layer_norm(x), sh1, sc1)
        hc = modulate(layer_norm(ctx), csh1, csc1)
        qa, ka, va, qb, kb, vb, ga, gb = project_streams(
            h, w_in[l], q_norm_a[l], k_norm_a[l], cq_norm[l], ckv_norm[l], w_uq[l], w_ukv[l], rows, cols)
        qac, kac, vac, qbc, kbc, vbc, gac, gbc = project_streams(
            hc, w_in[l], q_norm_a[l], k_norm_a[l], cq_norm[l], ckv_norm[l], w_uq[l], w_ukv[l], None, None)

        oa = block_attention(qa, jnp.concatenate([kac, ka], axis=1),
                             jnp.concatenate([vac, va], axis=1), A_SCALE)
        ob = block_attention(qb, jnp.concatenate([kbc, kb], axis=1),
                             jnp.concatenate([vbc, vb], axis=1), B_SCALE)
        y = merge_branches(oa, ob, ga, gb, w_proj_a[l], w_proj_b[l], w_out[l])

        if l < DEPTH - 1:
            oac = block_attention(qac, kac, vac, A_SCALE)
            obc = block_attention(qbc, kbc, vbc, B_SCALE)
            yc = merge_branches(oac, obc, gac, gbc, w_proj_a[l], w_proj_b[l], w_out[l])
            ctx = post_norm(ctx, cgt1 * yc, ln1_g[l], ln1_b[l])
            hc2 = modulate(layer_norm(ctx), csh2, csc2)
            ctx = post_norm(ctx, cgt2 * swiglu(hc2, w_up[l], w_down[l]), ln2_g[l], ln2_b[l])

        x = post_norm(x, gt1 * y, ln1_g[l], ln1_b[l])

        h2 = modulate(layer_norm(x), sh2, sc2)
        x = post_norm(x, gt2 * swiglu(h2, w_up[l], w_down[l]), ln2_g[l], ln2_b[l])
    return x
```

```cpp
#include <hip/hip_runtime.h>
#include <cstdint>
#include <cstdio>
#include <cmath>

constexpr int D = 1024, NB = 8, S = 2048, CTX = 256, TK = CTX + S;
constexpr int WIN = 3488, FF = 2816;
constexpr int O_QA = 0, O_KA = 512, O_VA = 640, O_CQ = 768, O_CKV = 1152, O_KR = 1408, O_GA = 1440, O_GB = 2464;
constexpr float EPS = 1e-6f;

__device__ __forceinline__ float silu_f(float v) { return v / (1.f + expf(-v)); }
__device__ __forceinline__ float sigm_f(float v) { return 1.f / (1.f + expf(-v)); }
__device__ __forceinline__ float wave_sum(float v) {
#pragma unroll
    for (int o = 1; o < 64; o <<= 1) v += __shfl_xor(v, o);
    return v;
}

__global__ void k_tables(float2* T16, float2* T8) {
    int i = blockIdx.x * blockDim.x + threadIdx.x;
    if (i < 64 * 16) { int pos = i / 16, j = i % 16; double a = (double)pos * pow(10000.0, -(double)j / 16.0); T16[i] = make_float2((float)cos(a), (float)sin(a)); }
    if (i < 64 * 8) { int pos = i / 8, j = i % 8; double a = (double)pos * pow(10000.0, -(double)j / 8.0); T8[i] = make_float2((float)cos(a), (float)sin(a)); }
}

__global__ void k_mod(const float* c, const float* c_ctx, const float* w_mod, const float* b_mod, float* mod) {
    int n = blockIdx.x * blockDim.x + threadIdx.x; int r = blockIdx.y;
    if (n >= 6 * D) return;
    const float* cv = r < 8 ? c + r * D : c_ctx;
    float acc = 0.f;
    for (int k = 0; k < D; ++k) acc += silu_f(cv[k]) * w_mod[(size_t)k * 6 * D + n];
    mod[r * 6 * D + n] = acc + b_mod[n];
}

__global__ void k_lnmod(const float* xb, const float* ctxb, const float* mod_b, const float* mod_c, float* H) {
    int row = blockIdx.x * 4 + (threadIdx.x >> 6), lane = threadIdx.x & 63;
    if (row >= TK) return;
    const float* src = row < CTX ? ctxb + (size_t)row * D : xb + (size_t)(row - CTX) * D;
    const float* md = row < CTX ? mod_c : mod_b;
    float v[16]; float s = 0.f;
#pragma unroll
    for (int j = 0; j < 16; ++j) { v[j] = src[lane + 64 * j]; s += v[j]; }
    float mean = wave_sum(s) * (1.f / D); float q = 0.f;
#pragma unroll
    for (int j = 0; j < 16; ++j) { v[j] -= mean; q += v[j] * v[j]; }
    float rstd = 1.f / sqrtf(wave_sum(q) * (1.f / D) + EPS);
#pragma unroll
    for (int j = 0; j < 16; ++j) { int col = lane + 64 * j; H[(size_t)row * D + col] = v[j] * rstd * (1.f + md[D + col]) + md[col]; }
}

__global__ void __launch_bounds__(256) k_sgemm(const float* A, int lda, const float* B, int ldb, float* C, int ldc, int M, int N, int K) {
    __shared__ float As[16][65], Bs[16][65];
    int tx = threadIdx.x & 15, ty = threadIdx.x >> 4; int m0 = blockIdx.y * 64, n0 = blockIdx.x * 64;
    float acc[4][4];
#pragma unroll
    for (int i = 0; i < 4; ++i)
#pragma unroll
        for (int j = 0; j < 4; ++j) acc[i][j] = 0.f;
    for (int k0 = 0; k0 < K; k0 += 16) {
        for (int e = threadIdx.x; e < 64 * 16; e += 256) { int mm = e / 16, kk = e % 16; int gm = m0 + mm; As[kk][mm] = gm < M ? A[(size_t)gm * lda + k0 + kk] : 0.f; }
        for (int e = threadIdx.x; e < 64 * 16; e += 256) { int kk = e / 64, nn = e % 64; int gn = n0 + nn; Bs[kk][nn] = gn < N ? B[(size_t)(k0 + kk) * ldb + gn] : 0.f; }
        __syncthreads();
#pragma unroll
        for (int kk = 0; kk < 16; ++kk) {
            float a[4], b[4];
#pragma unroll
            for (int i = 0; i < 4; ++i) { a[i] = As[kk][ty * 4 + i]; b[i] = Bs[kk][tx * 4 + i]; }
#pragma unroll
            for (int i = 0; i < 4; ++i)
#pragma unroll
                for (int j = 0; j < 4; ++j) acc[i][j] += a[i] * b[j];
        }
        __syncthreads();
    }
#pragma unroll
    for (int i = 0; i < 4; ++i)
#pragma unroll
        for (int j = 0; j < 4; ++j) { int gm = m0 + ty * 4 + i, gn = n0 + tx * 4 + j; if (gm < M && gn < N) C[(size_t)gm * ldc + gn] = acc[i][j]; }
}

__global__ void k_proj(const float* P, const float* qn, const float* kn, const float* cqn, const float* ckvn, const float2* T16, const float2* T8,
                       float* QA, float* KA, float* CQN, float* CKVN, float* KR) {
    int row = blockIdx.x * 4 + (threadIdx.x >> 6), lane = threadIdx.x & 63;
    if (row >= TK) return;
    const float* p = P + (size_t)row * WIN;
    bool lat = row >= CTX; int t = row - CTX; int pr = t / 64, pc = t % 64;
    for (int hh = 0; hh < 10; ++hh) {
        bool isq = hh < 8; if (isq && !lat) continue;
        const float* src = isq ? p + O_QA + hh * 64 : p + O_KA + (hh - 8) * 64;
        float v = src[lane]; float ss = wave_sum(v * v);
        float y = v * (1.f / sqrtf(ss * (1.f / 64.f) + EPS)) * (isq ? qn[lane] : kn[lane]);
        float o = y;
        if (lat) {
            int blk = lane >> 5, d = lane & 31, i = d & 15; int pos = blk == 0 ? pr : pc; float2 cs = T16[pos * 16 + i];
            float other = __shfl_xor(y, 16);
            o = (d < 16) ? y * cs.x - other * cs.y : other * cs.y + y * cs.x;
        }
        if (isq) QA[(size_t)t * 512 + hh * 64 + lane] = o; else KA[(size_t)row * 128 + (hh - 8) * 64 + lane] = o;
    }
    if (lat) { float v[6]; float ss = 0.f;
#pragma unroll
        for (int j = 0; j < 6; ++j) { v[j] = p[O_CQ + lane + 64 * j]; ss += v[j] * v[j]; }
        float r = 1.f / sqrtf(wave_sum(ss) * (1.f / 384.f) + EPS);
#pragma unroll
        for (int j = 0; j < 6; ++j) CQN[(size_t)t * 384 + lane + 64 * j] = v[j] * r * cqn[lane + 64 * j]; }
    { float v[4]; float ss = 0.f;
#pragma unroll
        for (int j = 0; j < 4; ++j) { v[j] = p[O_CKV + lane + 64 * j]; ss += v[j] * v[j]; }
        float r = 1.f / sqrtf(wave_sum(ss) * (1.f / 256.f) + EPS);
#pragma unroll
        for (int j = 0; j < 4; ++j) CKVN[(size_t)row * 256 + lane + 64 * j] = v[j] * r * ckvn[lane + 64 * j]; }
    { float y = lane < 32 ? p[O_KR + lane] : 0.f; float o = y;
      if (lat) { int l = lane & 31; int blk = l >> 4, d = l & 15, i = d & 7; int pos = blk == 0 ? pr : pc; float2 cs = T8[pos * 8 + i];
          float other = __shfl_xor(y, 8);
          o = (d < 8) ? y * cs.x - other * cs.y : other * cs.y + y * cs.x; }
      if (lane < 32) KR[(size_t)row * 32 + lane] = o; }
}

__global__ void k_ropeqb(float* QB, const float2* T8) {
    int t = blockIdx.x * 4 + (threadIdx.x >> 6), lane = threadIdx.x & 63;
    if (t >= S) return; int pr = t / 64, pc = t % 64;
    for (int it = 0; it < 4; ++it) { int idx = it * 64 + lane; int h = idx >> 5, l = idx & 31; int blk = l >> 4, d = l & 15, i = d & 7; int pos = blk == 0 ? pr : pc; float2 cs = T8[pos * 8 + i];
        float* q = QB + (size_t)t * 768 + h * 96 + 64;
        float y = q[l]; float other = __shfl_xor(y, 8);
        float o = (d < 8) ? y * cs.x - other * cs.y : other * cs.y + y * cs.x;
        q[l] = o; }
}

template <int D1, int D2, int DV>
__global__ void __launch_bounds__(256) k_attn(const float* Q, int qp, const float* K1, int k1p, const float* K2, int k2p, const float* V, int vp, float* O, int op, int G, float scale, int khs, int vhs) {
    constexpr int DQ = D1 + D2, KT = 16;
    __shared__ float Ks[KT][DQ], Vs[KT][DV];
    int h = blockIdx.y, kvh = h / G; int q = blockIdx.x * 256 + threadIdx.x;
    float qr[DQ], o[DV];
#pragma unroll
    for (int d = 0; d < DQ; ++d) qr[d] = Q[(size_t)q * qp + h * DQ + d] * scale;
#pragma unroll
    for (int d = 0; d < DV; ++d) o[d] = 0.f;
    float m = -1e30f, l = 0.f;
    for (int t0 = 0; t0 < TK; t0 += KT) {
        __syncthreads();
        for (int e = threadIdx.x; e < KT * DQ; e += 256) { int j = e / DQ, d = e % DQ; Ks[j][d] = d < D1 ? K1[(size_t)(t0 + j) * k1p + kvh * khs + d] : K2[(size_t)(t0 + j) * k2p + (d - D1)]; }
        for (int e = threadIdx.x; e < KT * DV; e += 256) { int j = e / DV, d = e % DV; Vs[j][d] = V[(size_t)(t0 + j) * vp + kvh * vhs + d]; }
        __syncthreads();
        float s[KT]; float tm = m;
#pragma unroll
        for (int j = 0; j < KT; ++j) { float a = 0.f;
#pragma unroll
            for (int d = 0; d < DQ; ++d) a += qr[d] * Ks[j][d];
            s[j] = a; tm = fmaxf(tm, a); }
        float f = expf(m - tm); l *= f;
#pragma unroll
        for (int d = 0; d < DV; ++d) o[d] *= f;
        m = tm;
#pragma unroll
        for (int j = 0; j < KT; ++j) { float pj = expf(s[j] - m); l += pj;
#pragma unroll
            for (int d = 0; d < DV; ++d) o[d] += pj * Vs[j][d]; }
    }
    float rl = 1.f / l;
#pragma unroll
    for (int d = 0; d < DV; ++d) O[(size_t)q * op + h * DV + d] = o[d] * rl;
}

__global__ void k_gate(const float* P, const float* PA, const float* PB, float* Y) {
    int i = blockIdx.x * blockDim.x + threadIdx.x; if (i >= S * D) return;
    int t = i / D, c = i % D; const float* p = P + (size_t)(CTX + t) * WIN;
    Y[i] = sigm_f(p[O_GA + c]) * PA[i] + sigm_f(p[O_GB + c]) * PB[i];
}

__global__ void k_postnorm(const float* xin, const float* Z, const float* gate, const float* g, const float* b, float* out1, const float* sh, const float* sc, float* H2) {
    int row = blockIdx.x * 4 + (threadIdx.x >> 6), lane = threadIdx.x & 63; if (row >= S) return;
    const float alpha = 1.189207115002721f;
    float v[16]; float s = 0.f;
#pragma unroll
    for (int j = 0; j < 16; ++j) { int col = lane + 64 * j; v[j] = alpha * xin[(size_t)row * D + col] + gate[col] * Z[(size_t)row * D + col]; s += v[j]; }
    float mean = wave_sum(s) * (1.f / D); float q = 0.f;
#pragma unroll
    for (int j = 0; j < 16; ++j) { v[j] -= mean; q += v[j] * v[j]; }
    float rstd = 1.f / sqrtf(wave_sum(q) * (1.f / D) + EPS);
    s = 0.f;
#pragma unroll
    for (int j = 0; j < 16; ++j) { int col = lane + 64 * j; v[j] = v[j] * rstd * g[col] + b[col]; out1[(size_t)row * D + col] = v[j]; s += v[j]; }
    if (H2) {
        mean = wave_sum(s) * (1.f / D); q = 0.f;
#pragma unroll
        for (int j = 0; j < 16; ++j) { v[j] -= mean; q += v[j] * v[j]; }
        rstd = 1.f / sqrtf(wave_sum(q) * (1.f / D) + EPS);
#pragma unroll
        for (int j = 0; j < 16; ++j) { int col = lane + 64 * j; H2[(size_t)row * D + col] = v[j] * rstd * (1.f + sc[col]) + sh[col]; }
    }
}

__global__ void k_swiglu(const float* UP, float* HH) {
    int i = blockIdx.x * blockDim.x + threadIdx.x; if (i >= S * FF) return;
    int t = i / FF, c = i % FF; float a = UP[(size_t)t * 2 * FF + c], u = UP[(size_t)t * 2 * FF + FF + c];
    HH[i] = silu_f(a) * u;
}

static void sgemm(const float* A, int lda, const float* B, int ldb, float* C, int ldc, int M, int N, int K, hipStream_t st) {
    dim3 g((N + 63) / 64, (M + 63) / 64); hipLaunchKernelGGL(k_sgemm, g, dim3(256), 0, st, A, lda, B, ldb, C, ldc, M, N, K);
}

extern "C" void kernel_launch(void* const* d_in, const int* in_sizes, int n_in, void* d_out, int out_size, void* d_ws, size_t ws_size, hipStream_t stream) {
    const float* x = (const float*)d_in[0]; const float* c = (const float*)d_in[1]; const float* ctx = (const float*)d_in[2]; const float* c_ctx = (const float*)d_in[3];
    const float* w_mod = (const float*)d_in[4]; const float* b_mod = (const float*)d_in[5]; const float* w_in = (const float*)d_in[6];
    const float* qn = (const float*)d_in[7]; const float* kn = (const float*)d_in[8]; const float* cqn = (const float*)d_in[9]; const float* ckvn = (const float*)d_in[10];
    const float* w_uq = (const float*)d_in[11]; const float* w_ukv = (const float*)d_in[12]; const float* w_pa = (const float*)d_in[13]; const float* w_pb = (const float*)d_in[14];
    const float* w_out = (const float*)d_in[15]; const float* ln1g = (const float*)d_in[16]; const float* ln1b = (const float*)d_in[17];
    const float* w_up = (const float*)d_in[18]; const float* w_down = (const float*)d_in[19]; const float* ln2g = (const float*)d_in[20]; const float* ln2b = (const float*)d_in[21];
    float* out = (float*)d_out; float* ws = (float*)d_ws; size_t o = 0;
    auto alloc = [&](size_t n) { float* p = ws + o; o += (n + 63) & ~(size_t)63; return p; };
    float* MOD = alloc(9 * 6 * D); float2* T16 = (float2*)alloc(64 * 16 * 2); float2* T8 = (float2*)alloc(64 * 8 * 2);
    float* H = alloc((size_t)TK * D); float* P = alloc((size_t)TK * WIN); float* QA = alloc((size_t)S * 512); float* KA = alloc((size_t)TK * 128);
    float* CQN = alloc((size_t)S * 384); float* CKVN = alloc((size_t)TK * 256); float* KR = alloc((size_t)TK * 32);
    float* QB = alloc((size_t)S * 768); float* KV = alloc((size_t)TK * 1024); float* OA = alloc((size_t)S * 512); float* OB = alloc((size_t)S * 512);
    float* PA = alloc((size_t)S * D); float* PB = alloc((size_t)S * D); float* Y = alloc((size_t)S * D); float* Z = alloc((size_t)S * D);
    float* X1 = alloc((size_t)S * D); float* H2 = alloc((size_t)S * D); float* UP = alloc((size_t)S * 2 * FF); float* HH = alloc((size_t)S * FF); float* F = alloc((size_t)S * D);
    if (o * 4 > ws_size) { fprintf(stderr, "ws too small\n"); return; }
    hipLaunchKernelGGL(k_tables, dim3(4), dim3(256), 0, stream, T16, T8);
    hipLaunchKernelGGL(k_mod, dim3(6 * D / 256, 9), dim3(256), 0, stream, c, c_ctx, w_mod, b_mod, MOD);
    for (int b = 0; b < NB; ++b) {
        const float* xb = x + (size_t)b * S * D; const float* ctxb = ctx + (size_t)b * CTX * D; const float* mb = MOD + b * 6 * D; const float* mc = MOD + 8 * 6 * D;
        hipLaunchKernelGGL(k_lnmod, dim3(TK / 4), dim3(256), 0, stream, xb, ctxb, mb, mc, H);
        sgemm(H, D, w_in, WIN, P, WIN, TK, WIN, D, stream);
        hipLaunchKernelGGL(k_proj, dim3(TK / 4), dim3(256), 0, stream, P, qn, kn, cqn, ckvn, T16, T8, QA, KA, CQN, CKVN, KR);
        sgemm(CQN, 384, w_uq, 768, QB, 768, S, 768, 384, stream);
        sgemm(CKVN, 256, w_ukv, 1024, KV, 1024, TK, 1024, 256, stream);
        hipLaunchKernelGGL(k_ropeqb, dim3(S / 4), dim3(256), 0, stream, QB, T8);
        hipLaunchKernelGGL((k_attn<64, 0, 64>), dim3(S / 256, 8), dim3(256), 0, stream, QA, 512, KA, 128, (const float*)nullptr, 0, P + O_VA, WIN, OA, 512, 4, 0.125f, 64, 64);
        hipLaunchKernelGGL((k_attn<64, 32, 64>), dim3(S / 256, 8), dim3(256), 0, stream, QB, 768, KV, 1024, KR, 32, KV + 64, 1024, OB, 512, 1, 0.10206207261596577f, 128, 128);
        sgemm(OA, 512, w_pa, D, PA, D, S, D, 512, stream);
        sgemm(OB, 512, w_pb, D, PB, D, S, D, 512, stream);
        hipLaunchKernelGGL(k_gate, dim3(S * D / 256), dim3(256), 0, stream, P, PA, PB, Y);
        sgemm(Y, D, w_out, D, Z, D, S, D, D, stream);
        hipLaunchKernelGGL(k_postnorm, dim3(S / 4), dim3(256), 0, stream, xb, Z, mb + 2 * D, ln1g, ln1b, X1, mb + 3 * D, mb + 4 * D, H2);
        sgemm(H2, D, w_up, 2 * FF, UP, 2 * FF, S, 2 * FF, D, stream);
        hipLaunchKernelGGL(k_swiglu, dim3(S * FF / 256), dim3(256), 0, stream, UP, HH);
        sgemm(HH, FF, w_down, D, F, D, S, D, FF, stream);
        hipLaunchKernelGGL(k_postnorm, dim3(S / 4), dim3(256), 0, stream, X1, F, mb + 5 * D, ln2g, ln2b, out + (size_t)b * S * D, (const float*)nullptr, (const float*)nullptr, (float*)nullptr);
    }
}
```
